# Optimizing an MI355X kernel written in HIP

```python
import jax, jax.numpy as jnp
from jax import lax
import numpy as np

D_MODEL = 1024
BATCH = 16
SEQ = 4096
DEPTH = 2

N_MIXERS = 2
RMS_EPS = 1e-6
GM_CHUNK = 128
GM_WIDTH = 2 * D_MODEL
GM_GROUPS = 8
GM_GROUP_DIM = GM_WIDTH // GM_GROUPS
RET_QK_DIM = 256
RET_HEADS = D_MODEL // RET_QK_DIM
RET_V_DIM = 2 * D_MODEL // RET_HEADS
RET_CHUNK = 128
ROPE_BASE = 10000.0
D_FF = 4 * D_MODEL
N_A = (DEPTH + 1) // 2
N_B = DEPTH // 2

kernel_name = "hybrid_gmlp_retention_trunk"


def rmsnorm(x, g):
    xf = x.astype(jnp.float32)
    y = xf * lax.rsqrt(jnp.mean(xf * xf, axis=-1, keepdims=True) + RMS_EPS)
    return (y * g.astype(jnp.float32)).astype(x.dtype)


def chunked_spatial_gating(xn, w_in, b_in, v_norm_g, w_s, b_s, w_out):
    B, S, _ = xn.shape
    nc = S // GM_CHUNK
    z = jax.nn.gelu(xn @ w_in + b_in)
    u, v = jnp.split(z, 2, axis=-1)
    v = rmsnorm(v, v_norm_g)
    v = v.reshape(B, nc, GM_CHUNK, GM_GROUPS, GM_GROUP_DIM)
    causal = jnp.tril(jnp.ones((GM_CHUNK, GM_CHUNK), dtype=bool))
    w = jnp.where(causal[None], w_s, 0.0)
    s = jnp.einsum('gts,bnsgc->bntgc', w, v) + b_s.T[:, :, None]
    s = s.reshape(B, S, GM_WIDTH)
    return (u * s) @ w_out


def rotary(t, cos, sin):
    t1, t2 = jnp.split(t, 2, axis=-1)
    return jnp.concatenate([t1 * cos - t2 * sin, t2 * cos + t1 * sin], axis=-1)


def retention(xn, w_in, head_norm_g, w_out):
    B, S, _ = xn.shape
    H, dk, dv, C = RET_HEADS, RET_QK_DIM, RET_V_DIM, RET_CHUNK
    nc = S // C
    f32 = jnp.float32
    proj = xn @ w_in
    q, k, v, g = jnp.split(proj, [H * dk, 2 * H * dk, 2 * H * dk + H * dv], axis=-1)
    q = q.reshape(B, S, H, dk).astype(f32)
    k = k.reshape(B, S, H, dk).astype(f32) * (dk ** -0.5)
    v = v.reshape(B, S, H, dv).astype(f32)
    pos = jnp.arange(S, dtype=f32)
    inv_freq = 1.0 / (ROPE_BASE ** jnp.linspace(0.0, 1.0, dk // 2, dtype=f32))
    ang = pos[:, None] * inv_freq[None, :]
    cos = jnp.cos(ang)[None, :, None, :]
    sin = jnp.sin(ang)[None, :, None, :]
    q = rotary(q, cos, sin)
    k = rotary(k, cos, sin)
    log_gamma = jnp.log(1.0 - 2.0 ** (-5.0 - jnp.arange(H, dtype=f32)))
    idx = jnp.arange(C, dtype=f32)
    diff = idx[:, None] - idx[None, :]
    inner_decay = jnp.where(diff >= 0, jnp.exp(log_gamma[:, None, None] * jnp.maximum(diff, 0.0)), 0.0)
    query_decay = jnp.exp(log_gamma[:, None] * (idx + 1.0))[None, :, :, None]
    key_decay = jnp.exp(log_gamma[:, None] * (C - 1.0 - idx))[None, :, :, None]
    chunk_decay = jnp.exp(log_gamma * C)[None, :, None, None]

    def to_chunks(t):
        return t.reshape(B, nc, C, H, t.shape[-1]).transpose(1, 0, 3, 2, 4)

    def step(state, qkv):
        qi, ki, vi = qkv
        scores = jnp.einsum('bhik,bhjk->bhij', qi, ki) * inner_decay
        o = jnp.einsum('bhij,bhjv->bhiv', scores, vi)
        o = o + jnp.einsum('bhik,bhkv->bhiv', qi * query_decay, state)
        state = state * chunk_decay + jnp.einsum('bhjk,bhjv->bhkv', ki * key_decay, vi)
        return state, o

    state0 = jnp.zeros((B, H, dk, dv), f32)
    _, o = lax.scan(step, state0, (to_chunks(q), to_chunks(k), to_chunks(v)))
    o = o.transpose(1, 0, 3, 2, 4).reshape(B, S, H, dv)
    o = rmsnorm(o, head_norm_g.reshape(H, dv)).reshape(B, S, H * dv)
    o = (o * jax.nn.silu(g.astype(f32))).astype(xn.dtype)
    return o @ w_out


def squared_relu_mlp(h, w1, w2):
    a = jax.nn.relu(h @ w1)
    return (a * a) @ w2


def setup_inputs(seed: int = 0) -> dict:
    key = jax.random.key(seed)
    ks = jax.random.split(key, 16)
    f32 = jnp.float32
    nrm = lambda k, shape, scale: jax.random.normal(k, shape, f32) * scale
    return {
        "x": nrm(ks[0], (BATCH, SEQ, D_MODEL), 1.0),
        "norm_mix_g": 1.0 + nrm(ks[1], (DEPTH, D_MODEL), 0.02),
        "norm_ffn_g": 1.0 + nrm(ks[2], (DEPTH, D_MODEL), 0.02),
        "a_w_in": nrm(ks[3], (N_A, D_MODEL, 2 * GM_WIDTH), D_MODEL ** -0.5),
        "a_b_in": nrm(ks[4], (N_A, 2 * GM_WIDTH), 0.02),
        "a_v_norm_g": 1.0 + nrm(ks[5], (N_A, GM_WIDTH), 0.02),
        "a_w_s": nrm(ks[6], (N_A, GM_GROUPS, GM_CHUNK, GM_CHUNK), GM_CHUNK ** -0.5),
        "a_b_s": 1.0 + nrm(ks[7], (N_A, GM_GROUPS, GM_CHUNK), 0.02),
        "a_w_out": nrm(ks[8], (N_A, GM_WIDTH, D_MODEL), GM_WIDTH ** -0.5),
        "b_w_in": nrm(ks[9], (N_B, D_MODEL, 2 * RET_HEADS * (RET_QK_DIM + RET_V_DIM)), D_MODEL ** -0.5),
        "b_head_norm_g": 1.0 + nrm(ks[10], (N_B, RET_HEADS * RET_V_DIM), 0.02),
        "b_w_out": nrm(ks[11], (N_B, RET_HEADS * RET_V_DIM, D_MODEL), (RET_HEADS * RET_V_DIM) ** -0.5),
        "mlp_w1": nrm(ks[12], (DEPTH, D_MODEL, D_FF), D_MODEL ** -0.5),
        "mlp_w2": nrm(ks[13], (DEPTH, D_FF, D_MODEL), D_FF ** -0.5),
        "final_norm_g": 1.0 + nrm(ks[14], (D_MODEL,), 0.02),
    }


def reference(x, norm_mix_g, norm_ffn_g, a_w_in, a_b_in, a_v_norm_g, a_w_s, a_b_s, a_w_out,
              b_w_in, b_head_norm_g, b_w_out, mlp_w1, mlp_w2, final_norm_g):
    for i in range(DEPTH):
        h = rmsnorm(x, norm_mix_g[i])
        j = i // N_MIXERS
        if i % N_MIXERS == 0:
            h = chunked_spatial_gating(h, a_w_in[j], a_b_in[j], a_v_norm_g[j], a_w_s[j], a_b_s[j], a_w_out[j])
        else:
            h = retention(h, b_w_in[j], b_head_norm_g[j], b_w_out[j])
        x = x + h
        h = rmsnorm(x, norm_ffn_g[i])
        x = x + squared_relu_mlp(h, mlp_w1[i], mlp_w2[i])
    return rmsnorm(x, final_norm_g)
```

```cpp
#include <hip/hip_runtime.h>
#include <hip/hip_cooperative_groups.h>
#include <cstdio>
namespace cg = cooperative_groups;
namespace pg8 {
#define PG8_LAS __attribute__((address_space(3)))
typedef unsigned short bf16_t;
typedef short bf16x8 __attribute__((ext_vector_type(8)));
typedef float f32x4 __attribute__((ext_vector_type(4)));
typedef unsigned u32x4 __attribute__((ext_vector_type(4)));
constexpr int BM = 256, BK = 64, HALF = 128, HTB = HALF * BK * 2  , STAGE_BYTES = 8 * HTB, NXCD = 8, WGM = 8;

__host__ __device__ __forceinline__ int lds_byte(int r, int c) { const int st = (r >> 4) * 2 + (c >> 5), rr = r & 15, cc = c & 31, ob = rr * 64 + cc * 2; return st * 1024 + (ob ^ (((ob >> 9) & 1) << 5)); }
__host__ __device__ __forceinline__ void stage_rc(int b, int& R, int& C) { const int st = b / 1024, sb = b % 1024, swz = sb ^ (((sb >> 9) & 1) << 5); R = (st >> 1) * 16 + swz / 64; C = (st & 1) * 32 + (swz % 64) / 2; }
__host__ __device__ __forceinline__ int perm32(int rho) { const int n = rho >> 4, i = rho & 15; return 8 * (i >> 2) + 4 * n + (i & 3); }

struct Unit { int pm, pn; };
struct Gemm { const bf16_t* A; const bf16_t* Bt; int M, N, K; };

struct StaticOrder {
    int nM, nN, nwg, G, c;
    __host__ __device__ void init(int M, int N, int G_, int c_) { nM = M / BM; nN = N / BM; nwg = nM * nN; G = G_; c = c_; }
    __host__ __device__ bool next(int i, Unit& u) const {
        const long L = (long)i * G + c; if (L >= nwg) return false;
        int wgid = (int)L; { const int q = nwg / NXCD, r = nwg % NXCD, xcd = wgid % NXCD, off = wgid / NXCD; wgid = (xcd < r ? xcd * (q + 1) : r * (q + 1) + (xcd - r) * q) + off; }
        const int nig = WGM * nN, gid = wgid / nig, fm = gid * WGM, gsz = (nM - fm) < WGM ? (nM - fm) : WGM;
        u.pm = fm + ((wgid % nig) % gsz); u.pn = (wgid % nig) / gsz; return true;
    }
    __device__ __forceinline__ void a_ready(const Unit&) const {}
    __device__ __forceinline__ void done(const Unit&) const {}
};
__device__ __forceinline__ unsigned cvt_pk_bf16(float lo, float hi) { unsigned r; asm volatile("v_cvt_pk_bf16_f32 %0, %1, %2" : "=v"(r) : "v"(lo), "v"(hi)); return r; }
typedef float f32x2 __attribute__((ext_vector_type(2)));
__device__ __forceinline__ f32x2 gelu_pk(f32x2 v) {
    const f32x2 av = __builtin_elementwise_abs(v), d = av * 0.2316418882f + 1.0f;
    f32x2 t; t.x = __builtin_amdgcn_rcpf(d.x); t.y = __builtin_amdgcn_rcpf(d.y);
    f32x2 q = t * 0.5307027145f + (-0.7265760135f); q = q * t + 0.7107068705f; q = q * t + (-0.142248368f); q = q * t + 0.127414796f; q = q * t;
    const f32x2 s = (v * v) * (-0.72134752044f);
    f32x2 e; e.x = __builtin_amdgcn_exp2f(s.x); e.y = __builtin_amdgcn_exp2f(s.y);
    const f32x2 m = v * (q * e), r = v - m;
    f32x2 o; o.x = v.x < 0.f ? m.x : r.x; o.y = v.y < 0.f ? m.y : r.y; return o;
}
template <class Epi, class Sched, bool STAMP = false>
__device__ __forceinline__ void gemm_phase(PG8_LAS unsigned char* lds, const Gemm g, const Sched& S, const Epi& E, unsigned long long* stamps) {
    const int tid = threadIdx.x, wid = __builtin_amdgcn_readfirstlane(tid >> 6), lane = tid & 63, wr = wid >> 2, wc = wid & 3, fr = lane & 15, fq = lane >> 4;
    const int K = g.K, nt = K / BK;
    int ts_lo = 0, ts_hi = 0, nts = 0; const unsigned long long rt_entry = STAMP ? (unsigned long long)wall_clock64() : 0ull;
#define PG8_STAMP() do { if (STAMP && wid == 0 && nts < 64) { const unsigned long long _c = (unsigned long long)clock64(); \
        ts_lo = (lane == nts) ? (int)(unsigned)_c : ts_lo; ts_hi = (lane == nts) ? (int)(unsigned)(_c >> 32) : ts_hi; ++nts; } } while (0)
    PG8_STAMP();
    unsigned voffA[2], voffB[2];
#pragma unroll
    for (int i = 0; i < 2; ++i) { int R, C; stage_rc(tid * 16 + i * 8192, R, C); const int Rb = Epi::PERM ? ((R & ~31) + perm32(R & 31)) : R;
        voffA[i] = (unsigned)(R * K + C) * 2u; voffB[i] = (unsigned)(Rb * K + C) * 2u; }
    const size_t kstep = (size_t)(BK * 2);
    const size_t hstep = (size_t)HALF * K * 2;
    const size_t tstep = 2 * hstep;
    const unsigned ldsw = (unsigned)wid * 1024u;
    const int aoff = lds_byte(wr * 64 + fr, fq * 8), boff = lds_byte(wc * 32 + fr, fq * 8);
#define PG8_SA(b, h) (((b) * 2 + (h)) * HTB)
#define PG8_SB(b, h) ((4 + (b) * 2 + (h)) * HTB)
#define PG8_STAGE(bufoff, gbase, voff) do { _Pragma("unroll") for (int _i = 0; _i < 2; ++_i) \
        __builtin_amdgcn_global_load_lds((const unsigned*)((const char*)(gbase) + (voff)[_i]), (PG8_LAS unsigned*)(lds + (bufoff) + ldsw + _i * 8192), 16, 0, 0); } while (0)
#define PG8_LDA(dst, b, h) do { _Pragma("unroll") for (int m = 0; m < 4; ++m) _Pragma("unroll") for (int k = 0; k < 2; ++k) dst[m][k] = *(const PG8_LAS bf16x8*)(lds + PG8_SA(b, h) + aoff + m * 2048 + k * 1024); } while (0)
#define PG8_LDB(dst, b, h) do { _Pragma("unroll") for (int n = 0; n < 2; ++n) _Pragma("unroll") for (int k = 0; k < 2; ++k) dst[n][k] = *(const PG8_LAS bf16x8*)(lds + PG8_SB(b, h) + boff + n * 2048 + k * 1024); } while (0)
#define PG8_MMA(ai, bj, At, Bt) do { __builtin_amdgcn_s_setprio(1); _Pragma("unroll") for (int m = 0; m < 4; ++m) _Pragma("unroll") for (int n = 0; n < 2; ++n) _Pragma("unroll") for (int k = 0; k < 2; ++k) \
        acc[ai][bj][m][n] = __builtin_amdgcn_mfma_f32_16x16x32_bf16(Bt[n][k], At[m][k], acc[ai][bj][m][n], 0, 0, 0); __builtin_amdgcn_s_setprio(0); } while (0)
#define PG8_WAIT_V(n) asm volatile("s_waitcnt vmcnt(" #n ")" ::: "memory")
#define PG8_WAIT_L(n) asm volatile("s_waitcnt lgkmcnt(" #n ")" ::: "memory")
#define PG8_BAR __builtin_amdgcn_s_barrier()
#define PG8_SCHED __builtin_amdgcn_sched_barrier(0)
    Unit cur, nxt; int ui = 0;
    if (!S.next(0, cur)) return;
    f32x4 acc[2][2][4][2];
#pragma unroll
    for (int a = 0; a < 2; ++a)
#pragma unroll
        for (int b = 0; b < 2; ++b)
#pragma unroll
            for (int m = 0; m < 4; ++m)
#pragma unroll
                for (int n = 0; n < 2; ++n) acc[a][b][m][n] = (f32x4){0.f, 0.f, 0.f, 0.f};
    bf16x8 At[4][2], B0[2][2], B1[2][2];
    const char* cA = (const char*)g.A + (size_t)cur.pm * tstep; const char* cB = (const char*)g.Bt + (size_t)cur.pn * tstep;
    S.a_ready(cur);
    PG8_STAGE(PG8_SB(0, 0), cB, voffB); PG8_STAGE(PG8_SA(0, 0), cA, voffA); PG8_STAGE(PG8_SB(0, 1), cB + hstep, voffB); PG8_STAGE(PG8_SA(0, 1), cA + hstep, voffA);
    if (wr == 1) PG8_BAR;
    PG8_WAIT_V(4); PG8_BAR;
    PG8_STAGE(PG8_SB(1, 0), cB + kstep, voffB); PG8_STAGE(PG8_SA(1, 0), cA + kstep, voffA); PG8_STAGE(PG8_SB(1, 1), cB + hstep + kstep, voffB);
    PG8_WAIT_V(6); PG8_BAR;
    PG8_STAMP();
    for (;;) {
        const bool has_next = S.next(ui + 1, nxt);
        const char* nA = has_next ? (const char*)g.A + (size_t)nxt.pm * tstep : cA; const char* nB = has_next ? (const char*)g.Bt + (size_t)nxt.pn * tstep : cB;
        for (int t = 0; t < nt; t += 2) {
            const bool last = (t == nt - 2);
            const char* a1 = cA + (size_t)(t + 1) * kstep;
            const char* a2 = last ? nA : cA + (size_t)(t + 2) * kstep; const char* b2 = last ? nB : cB + (size_t)(t + 2) * kstep;
            const char* a3 = a2 + kstep; const char* b3 = b2 + kstep;
            if (last && has_next) S.a_ready(nxt);
            PG8_LDB(B0, 0, 0); PG8_SCHED; PG8_LDA(At, 0, 0); PG8_STAGE(PG8_SA(1, 1), a1 + hstep, voffA);
            PG8_WAIT_L(8); PG8_BAR; PG8_WAIT_L(0); PG8_MMA(0, 0, At, B0); PG8_BAR; PG8_SCHED;
            PG8_LDB(B1, 0, 1); PG8_STAGE(PG8_SB(0, 0), b2, voffB);
            PG8_BAR; PG8_WAIT_L(0); PG8_MMA(0, 1, At, B1); PG8_BAR;
            PG8_LDA(At, 0, 1); PG8_STAGE(PG8_SA(0, 0), a2, voffA);
            PG8_BAR; PG8_WAIT_L(0); PG8_MMA(1, 0, At, B0); PG8_BAR; PG8_SCHED;
            PG8_STAGE(PG8_SB(0, 1), b2 + hstep, voffB);
            PG8_WAIT_V(6); PG8_BAR; PG8_MMA(1, 1, At, B1); PG8_BAR;
            PG8_LDB(B0, 1, 0); PG8_SCHED; PG8_LDA(At, 1, 0); PG8_STAGE(PG8_SA(0, 1), a2 + hstep, voffA);
            PG8_WAIT_L(8); PG8_BAR; PG8_WAIT_L(0); PG8_MMA(0, 0, At, B0); PG8_BAR; PG8_SCHED;
            PG8_LDB(B1, 1, 1); PG8_STAGE(PG8_SB(1, 0), b3, voffB);
            PG8_BAR; PG8_WAIT_L(0); PG8_MMA(0, 1, At, B1); PG8_BAR;
            PG8_LDA(At, 1, 1); PG8_STAGE(PG8_SA(1, 0), a3, voffA);
            PG8_BAR; PG8_WAIT_L(0); PG8_MMA(1, 0, At, B0); PG8_BAR; PG8_SCHED;
            PG8_STAGE(PG8_SB(1, 1), b3 + hstep, voffB);
            PG8_WAIT_V(6); PG8_BAR; PG8_MMA(1, 1, At, B1); PG8_BAR;
        }
        PG8_STAMP();
        if constexpr (!Epi::AFTER_DRAIN) { E(acc, cur, wr, wc, fr, fq); S.done(cur); }
        PG8_STAMP();
        if (!has_next) break;
#pragma unroll
        for (int a = 0; a < 2; ++a)
#pragma unroll
            for (int b = 0; b < 2; ++b)
#pragma unroll
                for (int m = 0; m < 4; ++m)
#pragma unroll
                    for (int n = 0; n < 2; ++n) acc[a][b][m][n] = (f32x4){0.f, 0.f, 0.f, 0.f};
        cur = nxt; cA = nA; cB = nB; ++ui;
    }
    PG8_WAIT_V(0);
    if (wr == 0) PG8_BAR;
    PG8_BAR;
    if constexpr (Epi::AFTER_DRAIN) { E.fused(acc, cur, wr, wc, fr, fq, lds, wid, lane); S.done(cur); }
    PG8_STAMP();
    if (STAMP && wid == 0) { stamps[lane] = lane < nts ? (((unsigned long long)(unsigned)ts_hi << 32) | (unsigned)ts_lo) : 0ull;
        if (lane == 62) stamps[62] = rt_entry; if (lane == 63) stamps[63] = (unsigned long long)wall_clock64(); }
#undef PG8_STAMP
#undef PG8_SA
#undef PG8_SB
#undef PG8_STAGE
#undef PG8_LDA
#undef PG8_LDB
#undef PG8_MMA
#undef PG8_WAIT_V
#undef PG8_WAIT_L
#undef PG8_BAR
#undef PG8_SCHED
}
}

#define LAS __attribute__((address_space(3)))
typedef unsigned short bf16_t;
typedef short bf16x8 __attribute__((ext_vector_type(8)));
typedef short s16x4 __attribute__((ext_vector_type(4)));
typedef float f32x4 __attribute__((ext_vector_type(4)));
typedef unsigned u32x4 __attribute__((ext_vector_type(4)));
typedef unsigned u32x2 __attribute__((ext_vector_type(2)));
typedef short v4i16_t __attribute__((ext_vector_type(4)));

constexpr int M_TOK = 65536, DM = 1024, SEQ = 4096;
constexpr float RMS_EPS = 1e-6f;
constexpr int NTHR = 512;
constexpr int LDS_BYTES = 147456;
constexpr int RC = 64;

constexpr size_t MiB = 1u << 20;
constexpr size_t WS_SS = 1 * MiB;
constexpr size_t WS_ROPE = 4 * MiB;
constexpr size_t WS_W = 8 * MiB;
constexpr size_t WS_WS = 68 * MiB;
constexpr size_t WS_XB = 72 * MiB;
constexpr size_t WS_BIG = 200 * MiB;
constexpr size_t WS_END = 968 * MiB;
constexpr size_t WO_AIN = 0, WO_AOUT = WO_AIN + 4096u * 1024, WO_W10 = WO_AOUT + 1024u * 2048, WO_W20 = WO_W10 + 4096u * 1024,
                 WO_BIN = WO_W20 + 1024u * 4096, WO_BOUT = WO_BIN + 6144u * 1024, WO_W11 = WO_BOUT + 1024u * 2048, WO_W21 = WO_W11 + 4096u * 1024,
                 WO_END = WO_W21 + 1024u * 4096;
static_assert(WO_END * 2 <= 60 * MiB, "weights");

struct Params {
    const float* x; const float* norm_mix_g; const float* norm_ffn_g; const float* a_w_in; const float* a_b_in; const float* a_v_norm_g;
    const float* a_w_s; const float* a_b_s; const float* a_w_out; const float* b_w_in; const float* b_head_norm_g; const float* b_w_out;
    const float* mlp_w1; const float* mlp_w2; const float* final_norm_g;
    float* out; unsigned char* ws;
};

__device__ __forceinline__ unsigned pkbf(float lo, float hi) { unsigned r; asm("v_cvt_pk_bf16_f32 %0, %1, %2" : "=v"(r) : "v"(lo), "v"(hi)); return r; }
__device__ __forceinline__ float bflo(unsigned w) { return __uint_as_float(w << 16); }
__device__ __forceinline__ float bfhi(unsigned w) { return __uint_as_float(w & 0xffff0000u); }
__device__ __forceinline__ float fast_rsq(float x) { return __builtin_amdgcn_rsqf(x); }
__device__ __forceinline__ float gelu_tanh(float x) {
    const float u = x * (1.0f + 0.044715f * x * x);
    const float e = __builtin_amdgcn_exp2f(u * (-2.0f * 0.7978845608028654f * 1.4426950408889634f));
    return x * __builtin_amdgcn_rcpf(1.0f + e);
}
__device__ __forceinline__ float silu_f(float x) { return x * __builtin_amdgcn_rcpf(1.0f + __builtin_amdgcn_exp2f(-1.4426950408889634f * x)); }
__device__ __forceinline__ void atomic_addf(float* p, float v) { unsafeAtomicAdd(p, v); }
__device__ __forceinline__ s16x4 tr_read(const LAS unsigned char* p) { return __builtin_bit_cast(s16x4, __builtin_amdgcn_ds_read_tr16_b64_v4i16((LAS v4i16_t*)p)); }
#define MFMA16(a, b, c) __builtin_amdgcn_mfma_f32_16x16x32_bf16((a), (b), (c), 0, 0, 0)

struct EpiGeluUV {
    static constexpr bool PERM = true, AFTER_DRAIN = false;
    bf16_t* U; bf16_t* V; const float* bias; float* ssv;
    __device__ __forceinline__ void operator()(const f32x4 (&acc)[2][2][4][2], const pg8::Unit& u, int wr, int wc, int fr, int fq) const {
        const int row0 = u.pm * 256 + wr * 64 + fr;
        const bool isv = u.pn >= 8;
        bf16_t* base = isv ? V : U;
        const int col0 = (u.pn & 7) * 256 + wc * 32 + 8 * fq, bcol0 = u.pn * 256 + wc * 32 + 8 * fq;
        f32x4 bv[2][2];
#pragma unroll
        for (int bj = 0; bj < 2; ++bj)
#pragma unroll
            for (int n = 0; n < 2; ++n) bv[bj][n] = *(const f32x4*)(bias + bcol0 + bj * 128 + 4 * n);
#pragma unroll
        for (int ai = 0; ai < 2; ++ai)
#pragma unroll
            for (int m = 0; m < 4; ++m) {
                const int row = row0 + ai * 128 + m * 16;
                bf16_t* rowp = base + (size_t)row * 2048 + col0; float ss = 0.f;
#pragma unroll
                for (int bj = 0; bj < 2; ++bj) {
                    f32x4 v0 = acc[ai][bj][m][0] + bv[bj][0], v1 = acc[ai][bj][m][1] + bv[bj][1];
#pragma unroll
                    for (int j = 0; j < 4; ++j) { v0[j] = gelu_tanh(v0[j]); v1[j] = gelu_tanh(v1[j]); ss += v0[j] * v0[j] + v1[j] * v1[j]; }
                    u32x4 w; w.x = pkbf(v0[0], v0[1]); w.y = pkbf(v0[2], v0[3]); w.z = pkbf(v1[0], v1[1]); w.w = pkbf(v1[2], v1[3]);
                    *(u32x4*)(rowp + bj * 128) = w;
                }
                if (isv) { ss += __shfl_xor(ss, 16); ss += __shfl_xor(ss, 32); if (fq == 0) atomic_addf(ssv + row, ss); }
            }
    }
};
struct EpiResid {
    static constexpr bool PERM = false, AFTER_DRAIN = false;
    const float* base; float* out; bf16_t* xb; float* ss;
    __device__ __forceinline__ void operator()(const f32x4 (&acc)[2][2][4][2], const pg8::Unit& u, int wr, int wc, int fr, int fq) const {
        const int row0 = u.pm * 256 + wr * 64 + fr, col0 = u.pn * 256 + wc * 32 + 4 * fq;
#pragma unroll
        for (int ai = 0; ai < 2; ++ai)
#pragma unroll
            for (int m = 0; m < 4; ++m) {
                const int row = row0 + ai * 128 + m * 16; const size_t off = (size_t)row * DM + col0; float s = 0.f;
#pragma unroll
                for (int bj = 0; bj < 2; ++bj)
#pragma unroll
                    for (int n = 0; n < 2; ++n) {
                        const f32x4 b = *(const f32x4*)(base + off + bj * 128 + n * 16);
                        const f32x4 o = b + acc[ai][bj][m][n];
                        *(f32x4*)(out + off + bj * 128 + n * 16) = o;
                        s += (o[0] * o[0] + o[1] * o[1]) + (o[2] * o[2] + o[3] * o[3]);
                        if (xb) { u32x2 w; w.x = pkbf(o[0], o[1]); w.y = pkbf(o[2], o[3]); *(u32x2*)(xb + off + bj * 128 + n * 16) = w; }
                    }
                s += __shfl_xor(s, 16); s += __shfl_xor(s, 32);
                if (fq == 0) atomic_addf(ss + row, s);
                asm volatile("" ::: "memory");
            }
    }
};
struct EpiRelu2 {
    static constexpr bool PERM = true, AFTER_DRAIN = false;
    bf16_t* H; const float* ss;
    __device__ __forceinline__ void operator()(const f32x4 (&acc)[2][2][4][2], const pg8::Unit& u, int wr, int wc, int fr, int fq) const {
        const int row0 = u.pm * 256 + wr * 64 + fr, col0 = u.pn * 256 + wc * 32 + 8 * fq;
#pragma unroll
        for (int ai = 0; ai < 2; ++ai)
#pragma unroll
            for (int m = 0; m < 4; ++m) {
                const int row = row0 + ai * 128 + m * 16;
                const float rs = fast_rsq(ss[row] * (1.0f / DM) + RMS_EPS);
                bf16_t* rowp = H + (size_t)row * 4096 + col0;
#pragma unroll
                for (int bj = 0; bj < 2; ++bj) {
                    f32x4 v0 = acc[ai][bj][m][0] * rs, v1 = acc[ai][bj][m][1] * rs;
#pragma unroll
                    for (int j = 0; j < 4; ++j) { const float a = fmaxf(v0[j], 0.f), b = fmaxf(v1[j], 0.f); v0[j] = a * a; v1[j] = b * b; }
                    u32x4 w; w.x = pkbf(v0[0], v0[1]); w.y = pkbf(v0[2], v0[3]); w.z = pkbf(v1[0], v1[1]); w.w = pkbf(v1[2], v1[3]);
                    *(u32x4*)(rowp + bj * 128) = w;
                }
            }
    }
};
struct EpiRetIn {
    static constexpr bool PERM = true, AFTER_DRAIN = false;
    bf16_t* Q; bf16_t* K; bf16_t* V; bf16_t* G; const float* ss; const float2* rope;
    __device__ __forceinline__ void operator()(const f32x4 (&acc)[2][2][4][2], const pg8::Unit& u, int wr, int wc, int fr, int fq) const {
        const int row0 = u.pm * 256 + wr * 64 + fr; const int pn = u.pn;
        if (pn < 8) {
            const bool isk = pn >= 4; const int h = pn & 3; bf16_t* dst = isk ? K : Q;
            const float lg = __builtin_amdgcn_logf(1.0f - __builtin_amdgcn_exp2f((float)(-5 - h)));
            const int i0 = wc * 32 + 8 * fq;
#pragma unroll
            for (int ai = 0; ai < 2; ++ai)
#pragma unroll
                for (int m = 0; m < 4; ++m) {
                    const int row = row0 + ai * 128 + m * 16;
                    const float rs = fast_rsq(ss[row] * (1.0f / DM) + RMS_EPS);
                    const int pos = row & (SEQ - 1); const float ii1 = (float)((pos & (RC - 1)) + 1);
                    const float sc = isk ? __builtin_amdgcn_exp2f(-lg * ii1) * 0.0625f : __builtin_amdgcn_exp2f(lg * ii1);
                    const float s2 = rs * sc;
                    const float2* rp = rope + (size_t)pos * 128 + i0;
                    float o1[8], o2[8];
#pragma unroll
                    for (int n = 0; n < 2; ++n)
#pragma unroll
                        for (int j = 0; j < 4; ++j) {
                            const float2 cs = rp[4 * n + j];
                            const float t1 = acc[ai][0][m][n][j] * s2, t2 = acc[ai][1][m][n][j] * s2;
                            o1[4 * n + j] = t1 * cs.x - t2 * cs.y; o2[4 * n + j] = t2 * cs.x + t1 * cs.y;
                        }
                    bf16_t* rowp = dst + (size_t)row * 1024 + h * 256 + i0;
                    u32x4 w; w.x = pkbf(o1[0], o1[1]); w.y = pkbf(o1[2], o1[3]); w.z = pkbf(o1[4], o1[5]); w.w = pkbf(o1[6], o1[7]);
                    *(u32x4*)(rowp) = w;
                    w.x = pkbf(o2[0], o2[1]); w.y = pkbf(o2[2], o2[3]); w.z = pkbf(o2[4], o2[5]); w.w = pkbf(o2[6], o2[7]);
                    *(u32x4*)(rowp + 128) = w;
                }
        } else {
            const bool isg = pn >= 16; bf16_t* dst = isg ? G : V;
            const int col0 = ((pn - 8) & 7) * 256 + wc * 32 + 8 * fq;
#pragma unroll
            for (int ai = 0; ai < 2; ++ai)
#pragma unroll
                for (int m = 0; m < 4; ++m) {
                    const int row = row0 + ai * 128 + m * 16;
                    const float rs = fast_rsq(ss[row] * (1.0f / DM) + RMS_EPS);
                    bf16_t* rowp = dst + (size_t)row * 2048 + col0;
#pragma unroll
                    for (int bj = 0; bj < 2; ++bj) {
                        f32x4 v0 = acc[ai][bj][m][0] * rs, v1 = acc[ai][bj][m][1] * rs;
                        if (isg) {
#pragma unroll
                            for (int j = 0; j < 4; ++j) { v0[j] = silu_f(v0[j]); v1[j] = silu_f(v1[j]); }
                        }
                        u32x4 w; w.x = pkbf(v0[0], v0[1]); w.y = pkbf(v0[2], v0[3]); w.z = pkbf(v1[0], v1[1]); w.w = pkbf(v1[2], v1[3]);
                        *(u32x4*)(rowp + bj * 128) = w;
                    }
                }
        }
    }
};

__device__ __forceinline__ float wave_sum(float v) {
#pragma unroll
    for (int o = 1; o < 64; o <<= 1) v += __shfl_xor(v, o);
    return v;
}
__device__ __forceinline__ void transpose_item(const float* W, const float* gain, int K, int N, bf16_t* WT, LAS float* scr, int item, int lane) {
    const int nblk = N / 32, kb = item / nblk, nb = item % nblk, k0 = 64 * kb, n0 = 32 * nb;
#pragma unroll 8
    for (int i = 0; i < 32; ++i) {
        const int kk = 2 * i + (lane >> 5);
        float v = W[(size_t)(k0 + kk) * N + n0 + (lane & 31)];
        if (gain) v *= gain[k0 + kk];
        scr[kk * 33 + (lane & 31)] = v;
    }
    asm volatile("s_waitcnt lgkmcnt(0)" ::: "memory");
    const int c = lane & 7;
#pragma unroll
    for (int j = 0; j < 4; ++j) {
        const int n = (lane >> 3) + 8 * j; const LAS float* s = scr + (8 * c) * 33 + n;
        u32x4 o; o.x = pkbf(s[0 * 33], s[1 * 33]); o.y = pkbf(s[2 * 33], s[3 * 33]); o.z = pkbf(s[4 * 33], s[5 * 33]); o.w = pkbf(s[6 * 33], s[7 * 33]);
        *(u32x4*)(WT + (size_t)(n0 + n) * K + k0 + 8 * c) = o;
    }
    asm volatile("s_waitcnt lgkmcnt(0)" ::: "memory");
}
__device__ __forceinline__ void sincos_acc(float ang, float& c, float& s) {
    const double x = (double)ang;
    const double kq = __builtin_rint(x * 0.63661977236758134308);
    const double r = (x - kq * 1.5707963267948966192) - kq * 6.123233995736766e-17;
    const double r2 = r * r;
    const double sp = r * (1.0 + r2 * (-1.0 / 6 + r2 * (1.0 / 120 + r2 * (-1.0 / 5040 + r2 * (1.0 / 362880 + r2 * (-1.0 / 39916800 + r2 * (1.0 / 6227020800.0)))))));
    const double cp = 1.0 + r2 * (-0.5 + r2 * (1.0 / 24 + r2 * (-1.0 / 720 + r2 * (1.0 / 40320 + r2 * (-1.0 / 3628800 + r2 * (1.0 / 479001600.0))))));
    const int q = ((int)kq) & 3;
    const double sv = (q == 0) ? sp : (q == 1) ? cp : (q == 2) ? -sp : -cp;
    const double cv = (q == 0) ? cp : (q == 1) ? -sp : (q == 2) ? -cp : sp;
    c = (float)cv; s = (float)sv;
}

__device__ __forceinline__ void phase0(const Params& p, LAS unsigned char* lds, int G) {
    const int tid = threadIdx.x, lane = tid & 63, wave = tid >> 6;
    const size_t gtid = (size_t)blockIdx.x * NTHR + tid, gthreads = (size_t)G * NTHR;
    unsigned char* ws = p.ws;
    { f32x4* z = (f32x4*)(ws + WS_SS); const size_t n = (size_t)M_TOK * 9 / 4; for (size_t i = gtid; i < n; i += gthreads) z[i] = (f32x4){0.f, 0.f, 0.f, 0.f}; }
    { float2* rope = (float2*)(ws + WS_ROPE);
      for (size_t i = gtid; i < (size_t)SEQ * 128; i += gthreads) {
          const int pos = (int)(i >> 7), fi = (int)(i & 127);
          const float t = (float)fi / 127.0f;
          const float pw = __builtin_amdgcn_exp2f(t * 13.287712379549449f);
          const float inv = 1.0f / pw;
          const float ang = (float)pos * inv;
          float c, s; sincos_acc(ang, c, s);
          rope[i] = make_float2(c, s);
      } }
    { bf16_t* wsb = (bf16_t*)(ws + WS_WS);
      for (size_t i = gtid; i < (size_t)8 * 128 * 128 / 2; i += gthreads) {
          const size_t e = 2 * i; const int t = (int)((e >> 7) & 127), s = (int)(e & 127);
          const float a = (s <= t) ? p.a_w_s[e] : 0.f, b = (s + 1 <= t) ? p.a_w_s[e + 1] : 0.f;
          ((unsigned*)wsb)[i] = pkbf(a, b);
      } }
    { LAS float* scr = (LAS float*)(lds + wave * 16384);
      bf16_t* wb = (bf16_t*)(ws + WS_W);
      const int gw = blockIdx.x * 8 + wave, NGW = G * 8;
      constexpr int I1 = 16 * 128, I2 = 32 * 32, I3 = 16 * 128, I4 = 64 * 32, I5 = 16 * 192, I6 = 32 * 32, I7 = 16 * 128, I8 = 64 * 32;
      constexpr int NIT = I1 + I2 + I3 + I4 + I5 + I6 + I7 + I8;
      for (int it = gw; it < NIT; it += NGW) {
          int r = it;
          if (r < I1) { transpose_item(p.a_w_in, p.norm_mix_g, 1024, 4096, wb + WO_AIN, scr, r, lane); continue; } r -= I1;
          if (r < I2) { transpose_item(p.a_w_out, nullptr, 2048, 1024, wb + WO_AOUT, scr, r, lane); continue; } r -= I2;
          if (r < I3) { transpose_item(p.mlp_w1, p.norm_ffn_g, 1024, 4096, wb + WO_W10, scr, r, lane); continue; } r -= I3;
          if (r < I4) { transpose_item(p.mlp_w2, nullptr, 4096, 1024, wb + WO_W20, scr, r, lane); continue; } r -= I4;
          if (r < I5) { transpose_item(p.b_w_in, p.norm_mix_g + 1024, 1024, 6144, wb + WO_BIN, scr, r, lane); continue; } r -= I5;
          if (r < I6) { transpose_item(p.b_w_out, p.b_head_norm_g, 2048, 1024, wb + WO_BOUT, scr, r, lane); continue; } r -= I6;
          if (r < I7) { transpose_item(p.mlp_w1 + (size_t)1024 * 4096, p.norm_ffn_g + 1024, 1024, 4096, wb + WO_W11, scr, r, lane); continue; } r -= I7;
          transpose_item(p.mlp_w2 + (size_t)4096 * 1024, nullptr, 4096, 1024, wb + WO_W21, scr, r, lane);
      }
      bf16_t* xb = (bf16_t*)(ws + WS_XB);
      for (int m = gw; m < M_TOK; m += NGW) {
          const f32x4* xr = (const f32x4*)(p.x + (size_t)m * DM) + lane;
          f32x4 v[4]; float s = 0.f;
#pragma unroll
          for (int j = 0; j < 4; ++j) { v[j] = xr[64 * j]; s += (v[j][0] * v[j][0] + v[j][1] * v[j][1]) + (v[j][2] * v[j][2] + v[j][3] * v[j][3]); }
          const float rstd = 1.0f / sqrtf(wave_sum(s) * (1.0f / DM) + RMS_EPS);
          u32x2* o8 = (u32x2*)(xb + (size_t)m * DM) + lane;
#pragma unroll
          for (int j = 0; j < 4; ++j) { u32x2 w; w.x = pkbf(v[j][0] * rstd, v[j][1] * rstd); w.y = pkbf(v[j][2] * rstd, v[j][3] * rstd); o8[64 * j] = w; }
      } }
}

__device__ __forceinline__ void phase_gate(const Params& p, LAS unsigned char* lds, int G) {
    constexpr int WST = 272, VST = 528;
    LAS unsigned char* Wl = lds; LAS unsigned char* Vl = lds + 128 * WST;
    const int tid = threadIdx.x, lane = tid & 63, w = __builtin_amdgcn_readfirstlane(tid >> 6), li = lane & 15, q = lane >> 4;
    unsigned char* ws = p.ws;
    bf16_t* Ub = (bf16_t*)(ws + WS_BIG); const bf16_t* Vb = (const bf16_t*)(ws + WS_BIG + 256 * MiB);
    const float* ssv = (const float*)(ws + WS_SS);
    const bf16_t* wsb = (const bf16_t*)(ws + WS_WS);
    int gprev = -1;
    for (int unit = blockIdx.x; unit < 4096; unit += G) {
        const int g = unit & 7, bn = unit >> 3; const int r0 = bn * 128, c0 = g * 256;
        __syncthreads();
        if (g != gprev) {
#pragma unroll
            for (int it = 0; it < 4; ++it) { const int id = tid + NTHR * it, row = id >> 4, ch = id & 15;
                const u32x4 v = *(const u32x4*)(wsb + (size_t)g * 16384 + row * 128 + ch * 8);
                *(LAS u32x4*)(Wl + row * WST + ch * 16) = v; }
            gprev = g;
        }
        { const int ch = tid & 31; const float* gp = p.a_v_norm_g + c0 + ch * 8;
          const f32x4 g0 = *(const f32x4*)gp, g1 = *(const f32x4*)(gp + 4);
#pragma unroll
          for (int it = 0; it < 8; ++it) { const int row = (tid >> 5) + 16 * it;
              const u32x4 v = *(const u32x4*)(Vb + (size_t)(r0 + row) * 2048 + c0 + ch * 8);
              const float rs = fast_rsq(ssv[r0 + row] * (1.0f / 2048.0f) + RMS_EPS);
              u32x4 o;
              o.x = pkbf(bflo(v.x) * rs * g0[0], bfhi(v.x) * rs * g0[1]); o.y = pkbf(bflo(v.y) * rs * g0[2], bfhi(v.y) * rs * g0[3]);
              o.z = pkbf(bflo(v.z) * rs * g1[0], bfhi(v.z) * rs * g1[1]); o.w = pkbf(bflo(v.w) * rs * g1[2], bfhi(v.w) * rs * g1[3]);
              *(LAS u32x4*)(Vl + row * VST + ch * 16) = o; } }
        __syncthreads();
        bf16x8 af[2][4];
#pragma unroll
        for (int mi = 0; mi < 2; ++mi)
#pragma unroll
            for (int ks = 0; ks < 4; ++ks) {
                const LAS unsigned char* a = Vl + (32 * ks + 8 * q + (li >> 2)) * VST + (32 * w + 16 * mi + 4 * (li & 3)) * 2;
                const s16x4 lo = tr_read(a), hi = tr_read(a + 4 * VST);
                af[mi][ks] = __builtin_shufflevector(lo, hi, 0, 1, 2, 3, 4, 5, 6, 7);
            }
#pragma unroll
        for (int tt = 0; tt < 8; ++tt) {
            f32x4 acc0 = (f32x4){0.f, 0.f, 0.f, 0.f}, acc1 = acc0;
#pragma unroll
            for (int ks = 0; ks < 4; ++ks) {
                if (ks <= (tt >> 1)) {
                    const bf16x8 bfr = *(const LAS bf16x8*)(Wl + (16 * tt + li) * WST + (32 * ks + 8 * q) * 2);
                    acc0 = MFMA16(af[0][ks], bfr, acc0); acc1 = MFMA16(af[1][ks], bfr, acc1);
                }
            }
            const int t = 16 * tt + li; const float bs = p.a_b_s[g * 128 + t];
            bf16_t* up = Ub + (size_t)(r0 + t) * 2048 + c0 + 32 * w + 4 * q;
            { const u32x2 uv = *(const u32x2*)up; u32x2 o;
              o.x = pkbf(bflo(uv.x) * (acc0[0] + bs), bfhi(uv.x) * (acc0[1] + bs)); o.y = pkbf(bflo(uv.y) * (acc0[2] + bs), bfhi(uv.y) * (acc0[3] + bs));
              *(u32x2*)up = o; }
            { const u32x2 uv = *(const u32x2*)(up + 16); u32x2 o;
              o.x = pkbf(bflo(uv.x) * (acc1[0] + bs), bfhi(uv.x) * (acc1[1] + bs)); o.y = pkbf(bflo(uv.y) * (acc1[2] + bs), bfhi(uv.y) * (acc1[3] + bs));
              *(u32x2*)(up + 16) = o; }
        }
    }
    __syncthreads();
}

__device__ __forceinline__ void phase_retention(const Params& p, LAS unsigned char* lds, int G) {
    constexpr int QST = 528, VST = 272, PST = 144;
    LAS unsigned char* Ql = lds; LAS unsigned char* Kl = lds + RC * QST; LAS unsigned char* Vl = Kl + RC * QST; LAS unsigned char* Pl = Vl + RC * VST;
    const int tid = threadIdx.x, lane = tid & 63, w = __builtin_amdgcn_readfirstlane(tid >> 6), li = lane & 15, q = lane >> 4;
    unsigned char* ws = p.ws;
    const bf16_t* Qb = (const bf16_t*)(ws + WS_BIG); const bf16_t* Kb = (const bf16_t*)(ws + WS_BIG + 128 * MiB);
    bf16_t* Vb = (bf16_t*)(ws + WS_BIG + 256 * MiB);
    float* ssh = (float*)(ws + WS_SS) + (size_t)5 * M_TOK;
    constexpr int NCH = SEQ / RC;
    for (int task = blockIdx.x; task < 256; task += G) {
        const int vs = task & 3, h = (task >> 2) & 3, b = task >> 4;
        const float gam = 1.0f - __builtin_amdgcn_exp2f((float)(-5 - h));
        const float cdec = __builtin_amdgcn_exp2f(__builtin_amdgcn_logf(gam) * (float)RC);
        const size_t rowb = (size_t)b * SEQ;
        const bf16_t* qg = Qb + rowb * 1024 + h * 256; const bf16_t* kg = Kb + rowb * 1024 + h * 256;
        bf16_t* vg = Vb + rowb * 2048 + h * 512 + vs * 128;
        f32x4 S[16];
#pragma unroll
        for (int t = 0; t < 16; ++t) S[t] = (f32x4){0.f, 0.f, 0.f, 0.f};
        u32x4 pq[4], pk[4], pv[2];
#define RET_PREFETCH(c) do { const size_t _r0 = (size_t)(c) * RC; \
            _Pragma("unroll") for (int it = 0; it < 4; ++it) { const int id = tid + NTHR * it, row = id >> 5, ch = id & 31; \
                pq[it] = *(const u32x4*)(qg + (_r0 + row) * 1024 + ch * 8); pk[it] = *(const u32x4*)(kg + (_r0 + row) * 1024 + ch * 8); } \
            _Pragma("unroll") for (int it = 0; it < 2; ++it) { const int id = tid + NTHR * it, row = id >> 4, ch = id & 15; \
                pv[it] = *(const u32x4*)(vg + (_r0 + row) * 2048 + ch * 8); } } while (0)
        RET_PREFETCH(0);
        for (int c = 0; c < NCH; ++c) {
            __syncthreads();
#pragma unroll
            for (int it = 0; it < 4; ++it) { const int id = tid + NTHR * it, row = id >> 5, ch = id & 31;
                *(LAS u32x4*)(Ql + row * QST + ch * 16) = pq[it]; *(LAS u32x4*)(Kl + row * QST + ch * 16) = pk[it]; }
#pragma unroll
            for (int it = 0; it < 2; ++it) { const int id = tid + NTHR * it, row = id >> 4, ch = id & 15;
                *(LAS u32x4*)(Vl + row * VST + ch * 16) = pv[it]; }
            __syncthreads();
            if (c + 1 < NCH) RET_PREFETCH(c + 1);
            {
                const int it = w >> 1;
#pragma unroll
                for (int jj = 0; jj < 2; ++jj) {
                    const int jt = 2 * (w & 1) + jj;
                    f32x4 pa = (f32x4){0.f, 0.f, 0.f, 0.f};
                    if (jt <= it) {
#pragma unroll
                        for (int ks = 0; ks < 8; ++ks) {
                            const bf16x8 a = *(const LAS bf16x8*)(Kl + (16 * jt + li) * QST + (32 * ks + 8 * q) * 2);
                            const bf16x8 bq = *(const LAS bf16x8*)(Ql + (16 * it + li) * QST + (32 * ks + 8 * q) * 2);
                            pa = MFMA16(a, bq, pa);
                        }
                    }
                    const int i = 16 * it + li, j0 = 16 * jt + 4 * q;
                    u32x2 o; o.x = pkbf(j0 + 0 <= i ? pa[0] : 0.f, j0 + 1 <= i ? pa[1] : 0.f); o.y = pkbf(j0 + 2 <= i ? pa[2] : 0.f, j0 + 3 <= i ? pa[3] : 0.f);
                    *(LAS u32x2*)(Pl + i * PST + j0 * 2) = o;
                }
            }
            __syncthreads();
            bf16x8 vf[2];
#pragma unroll
            for (int ks = 0; ks < 2; ++ks) {
                const LAS unsigned char* a = Vl + (32 * ks + 8 * q + (li >> 2)) * VST + (16 * w + 4 * (li & 3)) * 2;
                const s16x4 lo = tr_read(a), hi = tr_read(a + 4 * VST);
                vf[ks] = __builtin_shufflevector(lo, hi, 0, 1, 2, 3, 4, 5, 6, 7);
            }
            f32x4 oacc[4];
#pragma unroll
            for (int it = 0; it < 4; ++it) oacc[it] = (f32x4){0.f, 0.f, 0.f, 0.f};
#pragma unroll
            for (int ks = 0; ks < 8; ++ks) {
                u32x4 sa; sa.x = pkbf(S[2 * ks][0], S[2 * ks][1]); sa.y = pkbf(S[2 * ks][2], S[2 * ks][3]);
                sa.z = pkbf(S[2 * ks + 1][0], S[2 * ks + 1][1]); sa.w = pkbf(S[2 * ks + 1][2], S[2 * ks + 1][3]);
                const bf16x8 sfrag = __builtin_bit_cast(bf16x8, sa);
#pragma unroll
                for (int it = 0; it < 4; ++it) {
                    const LAS unsigned char* qa = Ql + (16 * it + li) * QST + (32 * ks + 4 * q) * 2;
                    const s16x4 lo = *(const LAS s16x4*)qa, hi = *(const LAS s16x4*)(qa + 32);
                    const bf16x8 qf = __builtin_shufflevector(lo, hi, 0, 1, 2, 3, 4, 5, 6, 7);
                    oacc[it] = MFMA16(sfrag, qf, oacc[it]);
                }
            }
#pragma unroll
            for (int ks = 0; ks < 2; ++ks)
#pragma unroll
                for (int it = 0; it < 4; ++it) {
                    if (2 * ks <= it) {
                        const bf16x8 pf = *(const LAS bf16x8*)(Pl + (16 * it + li) * PST + (32 * ks + 8 * q) * 2);
                        oacc[it] = MFMA16(vf[ks], pf, oacc[it]);
                    }
                }
#pragma unroll
            for (int t = 0; t < 16; ++t) {
#pragma unroll
                for (int ks = 0; ks < 2; ++ks) {
                    const LAS unsigned char* a = Kl + (32 * ks + 8 * q + (li >> 2)) * QST + (16 * t + 4 * (li & 3)) * 2;
                    const s16x4 lo = tr_read(a), hi = tr_read(a + 4 * QST);
                    const bf16x8 kf = __builtin_shufflevector(lo, hi, 0, 1, 2, 3, 4, 5, 6, 7);
                    S[t] = MFMA16(kf, vf[ks], S[t]);
                }
                S[t] = S[t] * cdec;
            }
            const size_t r0 = rowb + (size_t)c * RC;
#pragma unroll
            for (int it = 0; it < 4; ++it) {
                const f32x4 o = oacc[it];
                float s = (o[0] * o[0] + o[1] * o[1]) + (o[2] * o[2] + o[3] * o[3]);
                s += __shfl_xor(s, 16); s += __shfl_xor(s, 32);
                const size_t row = r0 + 16 * it + li;
                if (q == 0) atomic_addf(ssh + row * 4 + h, s);
                u32x2 ow; ow.x = pkbf(o[0], o[1]); ow.y = pkbf(o[2], o[3]);
                *(u32x2*)(Vb + row * 2048 + h * 512 + vs * 128 + 16 * w + 4 * q) = ow;
            }
        }
#undef RET_PREFETCH
    }
    __syncthreads();
}

__device__ __forceinline__ void phase_normgate(const Params& p, int G) {
    unsigned char* ws = p.ws;
    u32x4* Ob = (u32x4*)(ws + WS_BIG + 256 * MiB); const u32x4* Gb = (const u32x4*)(ws + WS_BIG + 512 * MiB);
    const float* ssh = (const float*)(ws + WS_SS) + (size_t)5 * M_TOK;
    const size_t n = (size_t)M_TOK * 256, gthreads = (size_t)G * NTHR;
    for (size_t i = (size_t)blockIdx.x * NTHR + threadIdx.x; i < n; i += gthreads) {
        const size_t row = i >> 8; const int h = (int)((i >> 6) & 3);
        const float rs = fast_rsq(ssh[row * 4 + h] * (1.0f / 512.0f) + RMS_EPS);
        const u32x4 o = Ob[i], g = Gb[i]; u32x4 r;
        r.x = pkbf(bflo(o.x) * rs * bflo(g.x), bfhi(o.x) * rs * bfhi(g.x)); r.y = pkbf(bflo(o.y) * rs * bflo(g.y), bfhi(o.y) * rs * bfhi(g.y));
        r.z = pkbf(bflo(o.z) * rs * bflo(g.z), bfhi(o.z) * rs * bfhi(g.z)); r.w = pkbf(bflo(o.w) * rs * bflo(g.w), bfhi(o.w) * rs * bfhi(g.w));
        Ob[i] = r;
    }
}
__device__ __forceinline__ void phase_final(const Params& p, int G) {
    const float* ss = (const float*)(p.ws + WS_SS) + (size_t)4 * M_TOK;
    f32x4* o = (f32x4*)p.out; const f32x4* gn = (const f32x4*)p.final_norm_g;
    const size_t n = (size_t)M_TOK * 256, gthreads = (size_t)G * NTHR;
    for (size_t i = (size_t)blockIdx.x * NTHR + threadIdx.x; i < n; i += gthreads) {
        const size_t row = i >> 8; const float rs = fast_rsq(ss[row] * (1.0f / DM) + RMS_EPS);
        const f32x4 v = o[i], g = gn[i & 255];
        o[i] = (f32x4){v[0] * rs * g[0], v[1] * rs * g[1], v[2] * rs * g[2], v[3] * rs * g[3]};
    }
}

__global__ void __launch_bounds__(NTHR, 2) fwd_megakernel(Params p) {
    extern __shared__ __attribute__((aligned(16))) unsigned char lds_raw[];
    LAS unsigned char* lds = (LAS unsigned char*)lds_raw;
    cg::grid_group grid = cg::this_grid();
    const int G = gridDim.x;
    unsigned char* ws = p.ws;
    bf16_t* wb = (bf16_t*)(ws + WS_W);
    bf16_t* XB = (bf16_t*)(ws + WS_XB);
    float* SS = (float*)(ws + WS_SS);
    float *SSV = SS, *SSF0 = SS + M_TOK, *SSM1 = SS + 2 * (size_t)M_TOK, *SSF1 = SS + 3 * (size_t)M_TOK, *SSFIN = SS + 4 * (size_t)M_TOK;
    bf16_t* BIG = (bf16_t*)(ws + WS_BIG);
    bf16_t* Ub = BIG; bf16_t* Vb0 = (bf16_t*)(ws + WS_BIG + 256 * MiB);
    bf16_t* Hb = BIG;
    bf16_t* Qb = BIG; bf16_t* Kb = (bf16_t*)(ws + WS_BIG + 128 * MiB); bf16_t* Vb1 = (bf16_t*)(ws + WS_BIG + 256 * MiB); bf16_t* Gb = (bf16_t*)(ws + WS_BIG + 512 * MiB);

    phase0(p, lds, G);
    grid.sync();
    { pg8::Gemm g{XB, wb + WO_AIN, M_TOK, 4096, 1024}; pg8::StaticOrder S; S.init(M_TOK, 4096, G, (int)blockIdx.x);
      EpiGeluUV E{Ub, Vb0, p.a_b_in, SSV};
      pg8::gemm_phase<EpiGeluUV, pg8::StaticOrder>(lds, g, S, E, nullptr); }
    grid.sync();
    phase_gate(p, lds, G);
    grid.sync();
    { pg8::Gemm g{Ub, wb + WO_AOUT, M_TOK, 1024, 2048}; pg8::StaticOrder S; S.init(M_TOK, 1024, G, (int)blockIdx.x);
      EpiResid E{p.x, p.out, XB, SSF0};
      pg8::gemm_phase<EpiResid, pg8::StaticOrder>(lds, g, S, E, nullptr); }
    grid.sync();
    { pg8::Gemm g{XB, wb + WO_W10, M_TOK, 4096, 1024}; pg8::StaticOrder S; S.init(M_TOK, 4096, G, (int)blockIdx.x);
      EpiRelu2 E{Hb, SSF0};
      pg8::gemm_phase<EpiRelu2, pg8::StaticOrder>(lds, g, S, E, nullptr); }
    grid.sync();
    { pg8::Gemm g{Hb, wb + WO_W20, M_TOK, 1024, 4096}; pg8::StaticOrder S; S.init(M_TOK, 1024, G, (int)blockIdx.x);
      EpiResid E{p.out, p.out, XB, SSM1};
      pg8::gemm_phase<EpiResid, pg8::StaticOrder>(lds, g, S, E, nullptr); }
    grid.sync();
    { pg8::Gemm g{XB, wb + WO_BIN, M_TOK, 6144, 1024}; pg8::StaticOrder S; S.init(M_TOK, 6144, G, (int)blockIdx.x);
      EpiRetIn E{Qb, Kb, Vb1, Gb, SSM1, (const float2*)(ws + WS_ROPE)};
      pg8::gemm_phase<EpiRetIn, pg8::StaticOrder>(lds, g, S, E, nullptr); }
    grid.sync();
    phase_retention(p, lds, G);
    grid.sync();
    phase_normgate(p, G);
    grid.sync();
    { pg8::Gemm g{Vb1, wb + WO_BOUT, M_TOK, 1024, 2048}; pg8::StaticOrder S; S.init(M_TOK, 1024, G, (int)blockIdx.x);
      EpiResid E{p.out, p.out, XB, SSF1};
      pg8::gemm_phase<EpiResid, pg8::StaticOrder>(lds, g, S, E, nullptr); }
    grid.sync();
    { pg8::Gemm g{XB, wb + WO_W11, M_TOK, 4096, 1024}; pg8::StaticOrder S; S.init(M_TOK, 4096, G, (int)blockIdx.x);
      EpiRelu2 E{Hb, SSF1};
      pg8::gemm_phase<EpiRelu2, pg8::StaticOrder>(lds, g, S, E, nullptr); }
    grid.sync();
    { pg8::Gemm g{Hb, wb + WO_W21, M_TOK, 1024, 4096}; pg8::StaticOrder S; S.init(M_TOK, 1024, G, (int)blockIdx.x);
      EpiResid E{p.out, p.out, nullptr, SSFIN};
      pg8::gemm_phase<EpiResid, pg8::StaticOrder>(lds, g, S, E, nullptr); }
    grid.sync();
    phase_final(p, G);
}

extern "C" void kernel_launch(void* const* d_in, const int* in_sizes, int n_in, void* d_out, int out_size, void* d_ws, size_t ws_size, hipStream_t stream) {
    static int grid_blocks = 0;
    if (grid_blocks == 0) {
        if (n_in != 15 || out_size != M_TOK * DM || ws_size < WS_END) { fprintf(stderr, "kernel_launch: unexpected shapes (n_in %d out %d ws %zu)\n", n_in, out_size, ws_size); grid_blocks = -1; return; }
        int dev = 0, cus = 0, per_cu = 0;
        hipGetDevice(&dev);
        hipDeviceGetAttribute(&cus, hipDeviceAttributeMultiprocessorCount, dev);
        if (hipFuncSetAttribute((const void*)fwd_megakernel, hipFuncAttributeMaxDynamicSharedMemorySize, LDS_BYTES) != hipSuccess) { fprintf(stderr, "kernel_launch: hipFuncSetAttribute failed\n"); grid_blocks = -1; return; }
        if (hipOccupancyMaxActiveBlocksPerMultiprocessor(&per_cu, (const void*)fwd_megakernel, NTHR, LDS_BYTES) != hipSuccess || per_cu < 1) per_cu = 1;
        (void)hipGetLastError();
        grid_blocks = cus * per_cu;
        if (grid_blocks > 256) grid_blocks = 256;
    }
    if (grid_blocks < 0) return;
    Params p{};
    p.x = (const float*)d_in[0]; p.norm_mix_g = (const float*)d_in[1]; p.norm_ffn_g = (const float*)d_in[2]; p.a_w_in = (const float*)d_in[3];
    p.a_b_in = (const float*)d_in[4]; p.a_v_norm_g = (const float*)d_in[5]; p.a_w_s = (const float*)d_in[6]; p.a_b_s = (const float*)d_in[7];
    p.a_w_out = (const float*)d_in[8]; p.b_w_in = (const float*)d_in[9]; p.b_head_norm_g = (const float*)d_in[10]; p.b_w_out = (const float*)d_in[11];
    p.mlp_w1 = (const float*)d_in[12]; p.mlp_w2 = (const float*)d_in[13]; p.final_norm_g = (const float*)d_in[14];
    p.out = (float*)d_out; p.ws = (unsigned char*)d_ws;
    void* args[] = {&p};
    hipError_t e = hipLaunchCooperativeKernel((const void*)fwd_megakernel, dim3(grid_blocks), dim3(NTHR), args, LDS_BYTES, stream);
    if (e != hipSuccess) fprintf(stderr, "cooperative launch failed: %s (grid %d)\n", hipGetErrorString(e), grid_blocks);
}
```
